# Optimizing an MI355X kernel written in HIP

```python
import math
import jax, jax.numpy as jnp
from jax import lax
import numpy as np

D_MODEL = 1024
BATCH = 8
SEQ = 4096
DEPTH = 1

D_MIX = D_MODEL
ATTN_HEADS = 8
HEAD_DIM = 64
D_ATTN = ATTN_HEADS * HEAD_DIM
D_CONV = D_MIX - D_ATTN
CONV_GROUPS = 8
CONV_WIDTH = 31
IDX_HEADS = 8
IDX_DIM = 64
TOPK_MAX = 256
Q_BLOCK = 128
ROPE_THETA = 10000.0
PEER_HEADS = 8
PEER_NKEYS = 128
PEER_NEXPERTS = PEER_NKEYS * PEER_NKEYS
PEER_QDIM = 128
PEER_HALF = PEER_QDIM // 2
PEER_TOPK = 16
TOK_BLOCK = 128
LN_EPS = 1e-5
DEEPNORM_ALPHA = (2.0 * DEPTH) ** 0.25
DEEPNORM_BETA = (8.0 * DEPTH) ** -0.25

OFF_Q = 0
OFF_K = OFF_Q + D_ATTN
OFF_V = OFF_K + D_ATTN
OFF_QI = OFF_V + D_ATTN
OFF_KI = OFF_QI + IDX_HEADS * IDX_DIM
OFF_WI = OFF_KI + IDX_DIM
OFF_CONV = OFF_WI + IDX_HEADS
D_IN = OFF_CONV + 2 * D_CONV

kernel_name = "hybrid_dsa_conformer_peer_block"


def layer_norm(x, g, b):
    xf = x.astype(jnp.float32)
    mu = jnp.mean(xf, axis=-1, keepdims=True)
    var = jnp.mean(jnp.square(xf - mu), axis=-1, keepdims=True)
    y = (xf - mu) * lax.rsqrt(var + LN_EPS) * g.astype(jnp.float32) + b.astype(jnp.float32)
    return y.astype(x.dtype)


def rope(x):
    L, D = x.shape[1], x.shape[-1]
    pos = jnp.arange(L, dtype=jnp.float32)
    inv_freq = ROPE_THETA ** (-jnp.arange(0, D, 2, dtype=jnp.float32) / D)
    ang = pos[:, None] * inv_freq[None, :]
    cos = jnp.concatenate([jnp.cos(ang), jnp.cos(ang)], -1)[None, :, None, :]
    sin = jnp.concatenate([jnp.sin(ang), jnp.sin(ang)], -1)[None, :, None, :]
    xf = x.astype(jnp.float32)
    x1, x2 = xf[..., : D // 2], xf[..., D // 2:]
    rot = jnp.concatenate([-x2, x1], axis=-1)
    return (xf * cos + rot * sin).astype(x.dtype)


def dsa_sparse_attention(q, k, v, qi, ki, wi):
    B, L = q.shape[0], q.shape[1]
    n_sel = min(TOPK_MAX, L // 4)
    n_blk = L // Q_BLOCK
    key_pos = jnp.arange(L)
    scale = HEAD_DIM ** -0.5
    gather = jax.vmap(lambda tab, idx: tab[idx])

    def block(bi):
        start = bi * Q_BLOCK
        q_b = lax.dynamic_slice_in_dim(q, start, Q_BLOCK, axis=1)
        qi_b = lax.dynamic_slice_in_dim(qi, start, Q_BLOCK, axis=1)
        wi_b = lax.dynamic_slice_in_dim(wi, start, Q_BLOCK, axis=1)
        q_pos = start + jnp.arange(Q_BLOCK)
        causal = key_pos[None, :] <= q_pos[:, None]
        rel = jax.nn.relu(jnp.einsum('bqhd,bsd->bqhs', qi_b, ki).astype(jnp.float32))
        score = jnp.einsum('bqh,bqhs->bqs', wi_b.astype(jnp.float32), rel)
        score = jnp.where(causal[None], score, -jnp.inf)
        _, sel = lax.top_k(score, n_sel)
        sel_valid = sel <= q_pos[None, :, None]
        k_sel = gather(k, sel)
        v_sel = gather(v, sel)
        att = jnp.einsum('bqhd,bqkhd->bhqk', q_b, k_sel).astype(jnp.float32) * scale
        att = jnp.where(sel_valid[:, None], att, -jnp.inf)
        p = jax.nn.softmax(att, axis=-1).astype(v.dtype)
        return jnp.einsum('bhqk,bqkhd->bqhd', p, v_sel)

    out = lax.map(block, jnp.arange(n_blk))
    out = jnp.transpose(out, (1, 0, 2, 3, 4))
    return out.reshape(B, L, D_ATTN)


def conformer_conv(a, dw_w, dw_b, g, b):
    u, gate = jnp.split(a, 2, axis=-1)
    h = u * jax.nn.sigmoid(gate)
    h = lax.conv_general_dilated(
        h, dw_w[:, None, :].astype(h.dtype), window_strides=(1,),
        padding=[(CONV_WIDTH - 1, 0)],
        dimension_numbers=('NWC', 'WIO', 'NWC'),
        feature_group_count=D_CONV) + dw_b
    h = layer_norm(h, g, b)
    return jax.nn.silu(h)


def peer_ffn(x, w_q, sub1, sub2, u_tab, v_tab):
    B, L, D = x.shape
    xt = x.reshape(-1, TOK_BLOCK, D)

    def block(xb):
        q = (xb @ w_q).reshape(TOK_BLOCK, PEER_HEADS, PEER_QDIM)
        q1, q2 = q[..., :PEER_HALF], q[..., PEER_HALF:]
        s1 = jnp.einsum('thd,hnd->thn', q1, sub1).astype(jnp.float32)
        s2 = jnp.einsum('thd,hnd->thn', q2, sub2).astype(jnp.float32)
        v1, i1 = lax.top_k(s1, PEER_TOPK)
        v2, i2 = lax.top_k(s2, PEER_TOPK)
        cand = (v1[..., :, None] + v2[..., None, :]).reshape(TOK_BLOCK, PEER_HEADS, -1)
        cand_id = (i1[..., :, None] * PEER_NKEYS + i2[..., None, :]).reshape(TOK_BLOCK, PEER_HEADS, -1)
        top_s, pos = lax.top_k(cand, PEER_TOPK)
        expert = jnp.take_along_axis(cand_id, pos, axis=-1)
        g = jax.nn.softmax(top_s, axis=-1).astype(xb.dtype)
        u_e = u_tab[expert]
        v_e = v_tab[expert]
        act = jax.nn.gelu(jnp.einsum('thkd,td->thk', u_e, xb), approximate=False)
        return jnp.einsum('thk,thkd->td', g * act, v_e)

    y = lax.map(block, xt)
    return y.reshape(B, L, D)


def setup_inputs(seed: int = 0) -> dict:
    key = jax.random.key(seed)
    ks = jax.random.split(key, 20)
    f32 = jnp.float32
    nrm = lambda k, shape, s: jax.random.normal(k, shape, f32) * s
    gain = lambda k, shape: 1.0 + 0.02 * jax.random.normal(k, shape, f32)
    return {
        "x": jax.random.normal(ks[0], (BATCH, SEQ, D_MODEL), f32),
        "w_in": nrm(ks[1], (DEPTH, D_MODEL, D_IN), D_MODEL ** -0.5),
        "idx_k_ln_g": gain(ks[2], (DEPTH, IDX_DIM)),
        "idx_k_ln_b": nrm(ks[3], (DEPTH, IDX_DIM), 0.02),
        "conv_dw_w": nrm(ks[4], (DEPTH, CONV_WIDTH, D_CONV), CONV_WIDTH ** -0.5),
        "conv_dw_b": nrm(ks[5], (DEPTH, D_CONV), 0.02),
        "conv_ln_g": gain(ks[6], (DEPTH, D_CONV)),
        "conv_ln_b": nrm(ks[7], (DEPTH, D_CONV), 0.02),
        "w_out": nrm(ks[8], (DEPTH, D_MIX, D_MODEL), D_MIX ** -0.5 * DEEPNORM_BETA),
        "ln1_g": gain(ks[9], (DEPTH, D_MODEL)),
        "ln1_b": nrm(ks[10], (DEPTH, D_MODEL), 0.02),
        "peer_w_q": nrm(ks[11], (DEPTH, D_MODEL, PEER_HEADS * PEER_QDIM), D_MODEL ** -0.5),
        "peer_sub_keys1": nrm(ks[12], (DEPTH, PEER_HEADS, PEER_NKEYS, PEER_HALF), PEER_HALF ** -0.5),
        "peer_sub_keys2": nrm(ks[13], (DEPTH, PEER_HEADS, PEER_NKEYS, PEER_HALF), PEER_HALF ** -0.5),
        "peer_u": nrm(ks[14], (DEPTH, PEER_NEXPERTS, D_MODEL), D_MODEL ** -0.5),
        "peer_v": nrm(ks[15], (DEPTH, PEER_NEXPERTS, D_MODEL), DEEPNORM_BETA),
        "ln2_g": gain(ks[16], (DEPTH, D_MODEL)),
        "ln2_b": nrm(ks[17], (DEPTH, D_MODEL), 0.02),
    }


def reference(x, w_in, idx_k_ln_g, idx_k_ln_b, conv_dw_w, conv_dw_b, conv_ln_g,
              conv_ln_b, w_out, ln1_g, ln1_b, peer_w_q, peer_sub_keys1,
              peer_sub_keys2, peer_u, peer_v, ln2_g, ln2_b):
    B, L, _ = x.shape
    for l in range(DEPTH):
        proj = x @ w_in[l]
        q = rope(proj[..., OFF_Q:OFF_K].reshape(B, L, ATTN_HEADS, HEAD_DIM))
        k = rope(proj[..., OFF_K:OFF_V].reshape(B, L, ATTN_HEADS, HEAD_DIM))
        v = proj[..., OFF_V:OFF_QI].reshape(B, L, ATTN_HEADS, HEAD_DIM)
        qi = rope(proj[..., OFF_QI:OFF_KI].reshape(B, L, IDX_HEADS, IDX_DIM))
        ki = layer_norm(proj[..., OFF_KI:OFF_WI], idx_k_ln_g[l], idx_k_ln_b[l])
        ki = rope(ki[:, :, None, :])[:, :, 0, :]
        wi = proj[..., OFF_WI:OFF_CONV] * (IDX_HEADS ** -0.5)
        attn_out = dsa_sparse_attention(q, k, v, qi, ki, wi)
        conv_out = conformer_conv(proj[..., OFF_CONV:], conv_dw_w[l], conv_dw_b[l],
                                  conv_ln_g[l], conv_ln_b[l])
        mix = jnp.concatenate([attn_out, conv_out], axis=-1) @ w_out[l]
        x = layer_norm(DEEPNORM_ALPHA * x + mix, ln1_g[l], ln1_b[l])
        ffn = peer_ffn(x, peer_w_q[l], peer_sub_keys1[l], peer_sub_keys2[l],
                       peer_u[l], peer_v[l])
        x = layer_norm(DEEPNORM_ALPHA * x + ffn, ln2_g[l], ln2_b[l])
    return x
```

```cpp
#include <hip/hip_runtime.h>
#include <cstdint>
#include <cstdio>

typedef unsigned short bf16_t;
typedef unsigned long long u64;

constexpr int BATCH = 8, SEQ = 4096, DM = 1024, M = BATCH * SEQ;
constexpr int D_IN = 3144, OFF_Q = 0, OFF_K = 512, OFF_V = 1024, OFF_QI = 1536, OFF_KI = 2048, OFF_WI = 2112, OFF_CONV = 2120;
constexpr int NSEL = 256;
constexpr float LN_EPS = 1e-5f;
constexpr float ALPHA = 1.189207115002721f;
constexpr float C2 = 0.125f * 1.4426950408889634f;

__device__ __forceinline__ unsigned f2bf(float f) { unsigned u = __float_as_uint(f); return (u + 0x7fffu + ((u >> 16) & 1u)) >> 16; }
__device__ __forceinline__ float bf2f(unsigned h) { return __uint_as_float(h << 16); }
__device__ __forceinline__ float bfround(float f) { return bf2f(f2bf(f)); }

__device__ __forceinline__ float wave_sum(float v) {
#pragma unroll
    for (int o = 1; o < 64; o <<= 1) v += __shfl_xor(v, o);
    return v;
}
__device__ __forceinline__ float wave_max(float v) {
#pragma unroll
    for (int o = 1; o < 64; o <<= 1) v = fmaxf(v, __shfl_xor(v, o));
    return v;
}

constexpr size_t MiB = 1u << 20;
constexpr size_t WS_ROPE = 1 * MiB;
constexpr size_t WS_Q = 16 * MiB;
constexpr size_t WS_K = 48 * MiB;
constexpr size_t WS_V = 80 * MiB;
constexpr size_t WS_QI = 112 * MiB;
constexpr size_t WS_KI = 144 * MiB;
constexpr size_t WS_WI = 148 * MiB;
constexpr size_t WS_H = 152 * MiB;
constexpr size_t WS_MASK = 184 * MiB;
constexpr size_t WS_AC = 200 * MiB;
constexpr size_t WS_X1B = 264 * MiB;
constexpr size_t WS_QP = 328 * MiB;
constexpr size_t WS_EID = 392 * MiB;
constexpr size_t WS_GATE = 408 * MiB;
constexpr size_t WS_END = 424 * MiB;

__global__ void rope_table_kernel(float* cs, float* sn) {
    const int idx = blockIdx.x * blockDim.x + threadIdx.x;
    if (idx >= SEQ * 32) return;
    const int pos = idx >> 5, i = idx & 31;
    const float inv_freq = powf(10000.0f, -(float)(2 * i) / 64.0f);
    const float angf = (float)pos * inv_freq;
    const double ang = (double)angf;
    const double twopi = 6.283185307179586476925286766559;
    double r = ang - twopi * rint(ang / twopi);
    const double r2 = r * r;
    double s = 0.0, c = 0.0, ts = r, tc = 1.0;
#pragma unroll 1
    for (int n = 0; n < 14; ++n) { s += ts; c += tc; tc = -tc * r2 / ((2 * n + 1) * (2 * n + 2)); ts = -ts * r2 / ((2 * n + 2) * (2 * n + 3)); }
    cs[idx] = (float)c; sn[idx] = (float)s;
}

struct GemmArgs {
    const void* A; const float* W; int K, N;
    int mode_base;
    const float* x; float* yout; bf16_t* bout;
    bf16_t *Q, *Kb, *V, *QI, *KI, *H; float* WI;
    const float *cs, *sn, *kg, *kb;
};
template <bool A_BF16>
__global__ void __launch_bounds__(256) naive_gemm_kernel(GemmArgs g) {
    __shared__ float As[16][68];
    __shared__ float Bs[16][68];
    __shared__ float Cs[64][65];
    const int tid = threadIdx.x, tx = tid & 15, ty = tid >> 4;
    const int row0 = blockIdx.x * 64, ct = blockIdx.y;
    int mode, sub = 0;
    if (g.mode_base == 0) {
        if (ct < 32) { const int reg = ct >> 3; sub = ct & 7; mode = (reg == 2) ? 1 : 0; }
        else if (ct == 32) mode = 2; else if (ct == 33) mode = 3; else { mode = 4; sub = ct - 34; }
    } else { mode = g.mode_base; sub = ct; }
    auto colmap = [&](int j) -> int {
        if (g.mode_base == 0) {
            if (ct < 32) return ct * 64 + j;
            if (ct == 32) return OFF_KI + j;
            if (ct == 33) return (j < 8) ? OFF_WI + j : -1;
            return (j < 32) ? OFF_CONV + sub * 32 + j : OFF_CONV + 512 + sub * 32 + (j - 32);
        }
        return ct * 64 + j;
    };
    int bcol[4];
#pragma unroll
    for (int j = 0; j < 4; ++j) bcol[j] = colmap((tid & 15) * 4 + j);
    float acc[4][4] = {};
    const int K = g.K, N = g.N;
    for (int k0 = 0; k0 < K; k0 += 16) {
        {
            const int r = tid >> 2, kq = tid & 3;
            float a[4];
            if (A_BF16) { const bf16_t* ap = (const bf16_t*)g.A + (size_t)(row0 + r) * K + k0 + 4 * kq; const uint2 v = *(const uint2*)ap;
                a[0] = bf2f(v.x & 0xffff); a[1] = bf2f(v.x >> 16); a[2] = bf2f(v.y & 0xffff); a[3] = bf2f(v.y >> 16); }
            else { const float4 v = *(const float4*)((const float*)g.A + (size_t)(row0 + r) * K + k0 + 4 * kq); a[0] = v.x; a[1] = v.y; a[2] = v.z; a[3] = v.w; }
#pragma unroll
            for (int i = 0; i < 4; ++i) As[4 * kq + i][r] = a[i];
        }
        {   const int k = tid >> 4;
#pragma unroll
            for (int j = 0; j < 4; ++j) Bs[k][(tid & 15) * 4 + j] = (bcol[j] >= 0) ? g.W[(size_t)(k0 + k) * N + bcol[j]] : 0.f;
        }
        __syncthreads();
#pragma unroll
        for (int k = 0; k < 16; ++k) {
            float a[4], b[4];
#pragma unroll
            for (int i = 0; i < 4; ++i) a[i] = As[k][ty * 4 + i];
#pragma unroll
            for (int j = 0; j < 4; ++j) b[j] = Bs[k][tx * 4 + j];
#pragma unroll
            for (int i = 0; i < 4; ++i)
#pragma unroll
                for (int j = 0; j < 4; ++j) acc[i][j] = fmaf(a[i], b[j], acc[i][j]);
        }
        __syncthreads();
    }
#pragma unroll
    for (int i = 0; i < 4; ++i)
#pragma unroll
        for (int j = 0; j < 4; ++j) Cs[ty * 4 + i][tx * 4 + j] = acc[i][j];
    __syncthreads();
    if (mode == 0) {
        const int reg = ct >> 3; bf16_t* dst = reg == 0 ? g.Q : (reg == 1 ? g.Kb : g.QI); const float sc = (reg == 0) ? C2 : 1.f;
        for (int e = tid; e < 64 * 32; e += 256) { const int r = e >> 5, i = e & 31; const int m = row0 + r, pos = m & (SEQ - 1);
            const float a = Cs[r][i], b = Cs[r][i + 32], c = g.cs[pos * 32 + i], s = g.sn[pos * 32 + i];
            const float o1 = a * c - b * s, o2 = b * c + a * s;
            *(unsigned*)(dst + (size_t)m * 512 + sub * 64 + 2 * i) = f2bf(o1 * sc) | (f2bf(o2 * sc) << 16); }
    } else if (mode == 1) {
        for (int e = tid; e < 64 * 64; e += 256) { const int r = e >> 6, j = e & 63; g.V[(size_t)(row0 + r) * 512 + sub * 64 + j] = (bf16_t)f2bf(Cs[r][j]); }
    } else if (mode == 2) {
        if (tid < 64) { const int r = tid; float mu = 0.f; for (int j = 0; j < 64; ++j) mu += Cs[r][j]; mu *= (1.f / 64.f);
            float var = 0.f; for (int j = 0; j < 64; ++j) { const float d = Cs[r][j] - mu; var += d * d; } var *= (1.f / 64.f);
            const float rs = rsqrtf(var + LN_EPS); const int m = row0 + r, pos = m & (SEQ - 1);
            for (int i = 0; i < 32; ++i) { const float a = (Cs[r][i] - mu) * rs * g.kg[i] + g.kb[i], b = (Cs[r][i + 32] - mu) * rs * g.kg[i + 32] + g.kb[i + 32];
                const float c = g.cs[pos * 32 + i], s = g.sn[pos * 32 + i];
                *(unsigned*)(g.KI + (size_t)m * 64 + 2 * i) = f2bf(a * c - b * s) | (f2bf(b * c + a * s) << 16); } }
    } else if (mode == 3) {
        for (int e = tid; e < 64 * 8; e += 256) { const int r = e >> 3, j = e & 7; g.WI[(size_t)(row0 + r) * 8 + j] = Cs[r][j] * 0.35355339059327373f; }
    } else if (mode == 4) {
        for (int e = tid; e < 64 * 32; e += 256) { const int r = e >> 5, j = e & 31; const float u = Cs[r][j], gt = Cs[r][j + 32];
            g.H[(size_t)(row0 + r) * 512 + sub * 32 + j] = (bf16_t)f2bf(u / (1.f + __expf(-gt))); }
    } else if (mode == 5) {
        for (int e = tid; e < 64 * 64; e += 256) { const int r = e >> 6, j = e & 63; const size_t o = (size_t)(row0 + r) * N + ct * 64 + j; g.yout[o] = ALPHA * g.x[o] + Cs[r][j]; }
    } else {
        for (int e = tid; e < 64 * 64; e += 256) { const int r = e >> 6, j = e & 63; g.bout[(size_t)(row0 + r) * N + ct * 64 + j] = (bf16_t)f2bf(Cs[r][j]); }
    }
}

__device__ __forceinline__ unsigned sortkey(float f) { const unsigned u = __float_as_uint(f); return (u & 0x80000000u) ? ~u : (u | 0x80000000u); }
__global__ void __launch_bounds__(256) naive_index_kernel(const bf16_t* __restrict__ QI, const bf16_t* __restrict__ KI, const float* __restrict__ WI, u64* __restrict__ MASK) {
    __shared__ float qs[512]; __shared__ float ws[8]; __shared__ unsigned keys[SEQ]; __shared__ int red[8]; __shared__ int s_cut;
    const int m = blockIdx.x, b = m >> 12, t = m & (SEQ - 1), tid = threadIdx.x, n = t + 1;
    for (int e = tid; e < 512; e += 256) qs[e] = bf2f(QI[(size_t)m * 512 + e]);
    if (tid < 8) ws[tid] = WI[(size_t)m * 8 + tid];
    __syncthreads();
    for (int s = tid; s < n; s += 256) {
        const uint4* kp = (const uint4*)(KI + (size_t)(b * SEQ + s) * 64);
        float kv[64];
#pragma unroll
        for (int c = 0; c < 8; ++c) { const uint4 v = kp[c]; kv[8 * c + 0] = bf2f(v.x & 0xffff); kv[8 * c + 1] = bf2f(v.x >> 16); kv[8 * c + 2] = bf2f(v.y & 0xffff); kv[8 * c + 3] = bf2f(v.y >> 16);
            kv[8 * c + 4] = bf2f(v.z & 0xffff); kv[8 * c + 5] = bf2f(v.z >> 16); kv[8 * c + 6] = bf2f(v.w & 0xffff); kv[8 * c + 7] = bf2f(v.w >> 16); }
        float sc = 0.f;
#pragma unroll
        for (int h = 0; h < 8; ++h) { float d = 0.f;
#pragma unroll
            for (int j = 0; j < 64; ++j) d = fmaf(qs[h * 64 + j], kv[j], d);
            sc = fmaf(ws[h], fmaxf(d, 0.f), sc); }
        keys[s] = sortkey(sc);
    }
    __syncthreads();
    unsigned Kth = 0; int cut = SEQ;
    if (n > NSEL) {
        auto block_count = [&](auto pred) -> int {
            int c = 0; for (int s = tid; s < n; s += 256) c += pred(keys[s]) ? 1 : 0;
            c = (int)wave_sum((float)c);
            __syncthreads(); if ((tid & 63) == 0) red[tid >> 6] = c; __syncthreads();
            return red[0] + red[1] + red[2] + red[3];
        };
        for (int bit = 31; bit >= 0; --bit) { const unsigned cand = Kth | (1u << bit); const int c = block_count([&](unsigned k) { return k >= cand; }); if (c >= NSEL) Kth = cand; }
        const int cgt = block_count([&](unsigned k) { return k > Kth; });
        const int ceq = block_count([&](unsigned k) { return k == Kth; });
        const int need = NSEL - cgt;
        if (ceq > need) {
            if (tid == 0) { int c = 0, cu = 0; for (int s = 0; s < n; ++s) if (keys[s] == Kth) { if (++c == need) { cu = s; break; } } s_cut = cu; }
            __syncthreads(); cut = s_cut;
        }
    }
    const int w = tid >> 6, lane = tid & 63;
    for (int kt = w; kt < 64; kt += 4) {
        const int s = kt * 64 + lane; bool sel = false;
        if (s < n) { if (n <= NSEL) sel = true; else { const unsigned k = keys[s]; sel = (k > Kth) || (k == Kth && s <= cut); } }
        const u64 bal = __ballot(sel);
        if (lane == 0) MASK[((size_t)b * 64 + kt) * SEQ + t] = bal;
    }
}

__global__ void __launch_bounds__(512) naive_attn_kernel(const bf16_t* __restrict__ Q, const bf16_t* __restrict__ Kb, const bf16_t* __restrict__ V, const u64* __restrict__ MASK, bf16_t* __restrict__ AC) {
    __shared__ int list[NSEL + 64]; __shared__ int s_cnt; __shared__ float qsh[8][64]; __shared__ float psh[8][NSEL];
    const int m = blockIdx.x, b = m >> 12, t = m & (SEQ - 1), tid = threadIdx.x, h = tid >> 6, lane = tid & 63;
    qsh[h][lane] = bf2f(Q[(size_t)m * 512 + h * 64 + lane]);
    if (tid < 64) {
        const u64 wd = MASK[((size_t)b * 64 + tid) * SEQ + t];
        const int pc = __popcll(wd);
        int incl = pc;
#pragma unroll
        for (int o = 1; o < 64; o <<= 1) { const int v = __shfl_up(incl, o); if (lane >= o) incl += v; }
        int pos = incl - pc; u64 x = wd;
        while (x) { const int bidx = __ffsll((long long)x) - 1; x &= x - 1; if (pos < NSEL) list[pos] = tid * 64 + bidx; ++pos; }
        if (tid == 63) s_cnt = incl;
    }
    __syncthreads();
    const int cnt = min(s_cnt, NSEL);
    float sv[4]; float mx = -INFINITY;
#pragma unroll
    for (int r = 0; r < 4; ++r) { const int j = lane + 64 * r; sv[r] = -INFINITY;
        if (j < cnt) { const int s = list[j]; const uint4* kp = (const uint4*)(Kb + (size_t)(b * SEQ + s) * 512 + h * 64); float d = 0.f;
#pragma unroll
            for (int c = 0; c < 8; ++c) { const uint4 v = kp[c]; const float* q = &qsh[h][8 * c];
                d = fmaf(q[0], bf2f(v.x & 0xffff), d); d = fmaf(q[1], bf2f(v.x >> 16), d); d = fmaf(q[2], bf2f(v.y & 0xffff), d); d = fmaf(q[3], bf2f(v.y >> 16), d);
                d = fmaf(q[4], bf2f(v.z & 0xffff), d); d = fmaf(q[5], bf2f(v.z >> 16), d); d = fmaf(q[6], bf2f(v.w & 0xffff), d); d = fmaf(q[7], bf2f(v.w >> 16), d); }
            sv[r] = d; mx = fmaxf(mx, d); } }
    mx = wave_max(mx);
    float l = 0.f;
#pragma unroll
    for (int r = 0; r < 4; ++r) { const int j = lane + 64 * r; const float p = (j < cnt) ? exp2f(sv[r] - mx) : 0.f; l += p; psh[h][j] = p; }
    l = wave_sum(l);
    __syncthreads();
    float o = 0.f;
    for (int j = 0; j < cnt; ++j) { const int s = list[j]; o = fmaf(psh[h][j], bf2f(V[(size_t)(b * SEQ + s) * 512 + h * 64 + lane]), o); }
    AC[(size_t)m * 1024 + h * 64 + lane] = (bf16_t)f2bf(o / l);
}

__global__ void __launch_bounds__(512) naive_conv_kernel(const bf16_t* __restrict__ H, const float* __restrict__ dw_w, const float* __restrict__ dw_b, const float* __restrict__ g, const float* __restrict__ bta, bf16_t* __restrict__ AC) {
    __shared__ float red[8]; __shared__ float red2[8];
    const int m = blockIdx.x, t = m & (SEQ - 1), c = threadIdx.x;
    float acc = dw_b[c];
    for (int j = 0; j < 31; ++j) { const int tt = t - 30 + j; if (tt >= 0) acc = fmaf(dw_w[j * 512 + c], bf2f(H[(size_t)(m - 30 + j) * 512 + c]), acc); }
    float s = wave_sum(acc); if ((c & 63) == 0) red[c >> 6] = s; __syncthreads();
    float mu = 0.f; for (int i = 0; i < 8; ++i) mu += red[i]; mu *= (1.f / 512.f);
    const float d = acc - mu; float s2 = wave_sum(d * d); if ((c & 63) == 0) red2[c >> 6] = s2; __syncthreads();
    float var = 0.f; for (int i = 0; i < 8; ++i) var += red2[i]; var *= (1.f / 512.f);
    const float y = d * rsqrtf(var + LN_EPS) * g[c] + bta[c];
    AC[(size_t)m * 1024 + 512 + c] = (bf16_t)f2bf(y / (1.f + __expf(-y)));
}

__global__ void __launch_bounds__(256) ln_rows_kernel(float* __restrict__ y, const float* __restrict__ g, const float* __restrict__ bta, bf16_t* __restrict__ xb) {
    const int row = blockIdx.x * 4 + (threadIdx.x >> 6), lane = threadIdx.x & 63;
    float4* yr = (float4*)(y + (size_t)row * DM) + lane; float4 v[4]; float s = 0.f;
#pragma unroll
    for (int j = 0; j < 4; ++j) { v[j] = yr[64 * j]; s += (v[j].x + v[j].y) + (v[j].z + v[j].w); }
    const float mu = wave_sum(s) * (1.f / DM); float s2 = 0.f;
#pragma unroll
    for (int j = 0; j < 4; ++j) { v[j].x -= mu; v[j].y -= mu; v[j].z -= mu; v[j].w -= mu; s2 += (v[j].x * v[j].x + v[j].y * v[j].y) + (v[j].z * v[j].z + v[j].w * v[j].w); }
    const float rs = rsqrtf(wave_sum(s2) * (1.f / DM) + LN_EPS);
#pragma unroll
    for (int j = 0; j < 4; ++j) { const int c = 256 * j + 4 * lane; const float4 gg = *(const float4*)(g + c), bb = *(const float4*)(bta + c);
        float4 o; o.x = v[j].x * rs * gg.x + bb.x; o.y = v[j].y * rs * gg.y + bb.y; o.z = v[j].z * rs * gg.z + bb.z; o.w = v[j].w * rs * gg.w + bb.w;
        yr[64 * j] = o; uint2 pk; pk.x = f2bf(o.x) | (f2bf(o.y) << 16); pk.y = f2bf(o.z) | (f2bf(o.w) << 16); *(uint2*)(xb + (size_t)row * DM + c) = pk; }
}

__device__ __forceinline__ void wave_argmax(float& v, int& i) {
#pragma unroll
    for (int o = 1; o < 64; o <<= 1) { const float ov = __shfl_xor(v, o); const int oi = __shfl_xor(i, o); if (ov > v || (ov == v && oi < i)) { v = ov; i = oi; } }
}
__global__ void __launch_bounds__(512) naive_route_kernel(const bf16_t* __restrict__ QP, const float* __restrict__ sub1, const float* __restrict__ sub2, int* __restrict__ EID, float* __restrict__ GATE) {
    const int m = blockIdx.x, h = threadIdx.x >> 6, lane = threadIdx.x & 63;
    float q1 = bf2f(QP[(size_t)m * 1024 + h * 128 + lane]), q2 = bf2f(QP[(size_t)m * 1024 + h * 128 + 64 + lane]);
    float s1[2] = {0.f, 0.f}, s2[2] = {0.f, 0.f};
    for (int d = 0; d < 64; ++d) { const float a = __shfl(q1, d), b = __shfl(q2, d);
#pragma unroll
        for (int r = 0; r < 2; ++r) { const int n = lane + 64 * r; s1[r] = fmaf(a, bfround(sub1[((size_t)h * 128 + n) * 64 + d]), s1[r]); s2[r] = fmaf(b, bfround(sub2[((size_t)h * 128 + n) * 64 + d]), s2[r]); } }
    float v1 = -INFINITY, v2 = -INFINITY; int i1 = 0, i2 = 0;
    for (int r = 0; r < 16; ++r) {
        { float bv = s1[0]; int bi = lane; if (s1[1] > bv) { bv = s1[1]; bi = lane + 64; } wave_argmax(bv, bi); if (lane == r) { v1 = bv; i1 = bi; } if (bi == lane) s1[0] = -INFINITY; if (bi == lane + 64) s1[1] = -INFINITY; }
        { float bv = s2[0]; int bi = lane; if (s2[1] > bv) { bv = s2[1]; bi = lane + 64; } wave_argmax(bv, bi); if (lane == r) { v2 = bv; i2 = bi; } if (bi == lane) s2[0] = -INFINITY; if (bi == lane + 64) s2[1] = -INFINITY; }
    }
    float cand[4];
#pragma unroll
    for (int j = 0; j < 4; ++j) { const int c = lane + 64 * j; cand[j] = __shfl(v1, c >> 4) + __shfl(v2, c & 15); }
    float ts = -INFINITY; int tp = 0;
    for (int r = 0; r < 16; ++r) {
        float bv = cand[0]; int bi = lane;
#pragma unroll
        for (int j = 1; j < 4; ++j) if (cand[j] > bv) { bv = cand[j]; bi = lane + 64 * j; }
        wave_argmax(bv, bi); if (lane == r) { ts = bv; tp = bi; }
#pragma unroll
        for (int j = 0; j < 4; ++j) if (bi == lane + 64 * j) cand[j] = -INFINITY;
    }
    const int ea = __shfl(i1, tp >> 4), eb = __shfl(i2, tp & 15);
    const float mx = __shfl(ts, 0);
    float p = (lane < 16) ? __expf(ts - mx) : 0.f;
    const float l = wave_sum(p);
    if (lane < 16) { EID[(size_t)m * 128 + h * 16 + lane] = ea * 128 + eb; GATE[(size_t)m * 128 + h * 16 + lane] = p / l; }
}

__global__ void __launch_bounds__(256) naive_peer_kernel(float* __restrict__ xio, const int* __restrict__ EID, const float* __restrict__ GATE, const float* __restrict__ U, const float* __restrict__ Vt,
                                                         const float* __restrict__ g, const float* __restrict__ bta) {
    const int m = blockIdx.x * 4 + (threadIdx.x >> 6), lane = threadIdx.x & 63;
    float4* xr = (float4*)(xio + (size_t)m * DM) + lane; float4 x[4], acc[4];
#pragma unroll
    for (int j = 0; j < 4; ++j) { x[j] = xr[64 * j]; acc[j] = make_float4(0.f, 0.f, 0.f, 0.f); }
    for (int k = 0; k < 128; ++k) {
        const int e = EID[(size_t)m * 128 + k]; const float gt = GATE[(size_t)m * 128 + k];
        const float4* ur = (const float4*)(U + (size_t)e * DM) + lane; const float4* vr = (const float4*)(Vt + (size_t)e * DM) + lane;
        float d = 0.f;
#pragma unroll
        for (int j = 0; j < 4; ++j) { const float4 u = ur[64 * j]; d += (u.x * x[j].x + u.y * x[j].y) + (u.z * x[j].z + u.w * x[j].w); }
        d = wave_sum(d);
        const float c = gt * 0.5f * d * (1.f + erff(d * 0.70710678118654752f));
#pragma unroll
        for (int j = 0; j < 4; ++j) { const float4 v = vr[64 * j]; acc[j].x = fmaf(c, v.x, acc[j].x); acc[j].y = fmaf(c, v.y, acc[j].y); acc[j].z = fmaf(c, v.z, acc[j].z); acc[j].w = fmaf(c, v.w, acc[j].w); }
    }
    float s = 0.f;
#pragma unroll
    for (int j = 0; j < 4; ++j) { acc[j].x += ALPHA * x[j].x; acc[j].y += ALPHA * x[j].y; acc[j].z += ALPHA * x[j].z; acc[j].w += ALPHA * x[j].w; s += (acc[j].x + acc[j].y) + (acc[j].z + acc[j].w); }
    const float mu = wave_sum(s) * (1.f / DM); float s2 = 0.f;
#pragma unroll
    for (int j = 0; j < 4; ++j) { acc[j].x -= mu; acc[j].y -= mu; acc[j].z -= mu; acc[j].w -= mu; s2 += (acc[j].x * acc[j].x + acc[j].y * acc[j].y) + (acc[j].z * acc[j].z + acc[j].w * acc[j].w); }
    const float rs = rsqrtf(wave_sum(s2) * (1.f / DM) + LN_EPS);
#pragma unroll
    for (int j = 0; j < 4; ++j) { const int c = 256 * j + 4 * lane; const float4 gg = *(const float4*)(g + c), bb = *(const float4*)(bta + c);
        float4 o; o.x = acc[j].x * rs * gg.x + bb.x; o.y = acc[j].y * rs * gg.y + bb.y; o.z = acc[j].z * rs * gg.z + bb.z; o.w = acc[j].w * rs * gg.w + bb.w; xr[64 * j] = o; }
}

extern "C" void kernel_launch(void* const* d_in, const int* in_sizes, int n_in, void* d_out, int out_size, void* d_ws, size_t ws_size, hipStream_t stream) {
    if (n_in != 18 || out_size != M * DM || ws_size < WS_END) { fprintf(stderr, "kernel_launch: unexpected shapes (n_in %d out %d ws %zu)\n", n_in, out_size, ws_size); return; }
    const float* x = (const float*)d_in[0]; const float* w_in = (const float*)d_in[1]; const float* kg = (const float*)d_in[2]; const float* kb = (const float*)d_in[3];
    const float* dw_w = (const float*)d_in[4]; const float* dw_b = (const float*)d_in[5]; const float* cg = (const float*)d_in[6]; const float* cb = (const float*)d_in[7];
    const float* w_out = (const float*)d_in[8]; const float* l1g = (const float*)d_in[9]; const float* l1b = (const float*)d_in[10]; const float* w_q = (const float*)d_in[11];
    const float* sub1 = (const float*)d_in[12]; const float* sub2 = (const float*)d_in[13]; const float* pu = (const float*)d_in[14]; const float* pv = (const float*)d_in[15];
    const float* l2g = (const float*)d_in[16]; const float* l2b = (const float*)d_in[17];
    unsigned char* ws = (unsigned char*)d_ws; float* out = (float*)d_out;
    float* cs = (float*)(ws + WS_ROPE); float* sn = cs + SEQ * 32;
    bf16_t *Q = (bf16_t*)(ws + WS_Q), *Kb = (bf16_t*)(ws + WS_K), *V = (bf16_t*)(ws + WS_V), *QI = (bf16_t*)(ws + WS_QI), *KI = (bf16_t*)(ws + WS_KI), *H = (bf16_t*)(ws + WS_H);
    float* WI = (float*)(ws + WS_WI); u64* MASK = (u64*)(ws + WS_MASK); bf16_t* AC = (bf16_t*)(ws + WS_AC); bf16_t* X1B = (bf16_t*)(ws + WS_X1B); bf16_t* QP = (bf16_t*)(ws + WS_QP);
    int* EID = (int*)(ws + WS_EID); float* GATE = (float*)(ws + WS_GATE);

    rope_table_kernel<<<SEQ * 32 / 256, 256, 0, stream>>>(cs, sn);
    { GemmArgs g{}; g.A = x; g.W = w_in; g.K = DM; g.N = D_IN; g.mode_base = 0; g.Q = Q; g.Kb = Kb; g.V = V; g.QI = QI; g.KI = KI; g.H = H; g.WI = WI; g.cs = cs; g.sn = sn; g.kg = kg; g.kb = kb;
      naive_gemm_kernel<false><<<dim3(M / 64, 50), 256, 0, stream>>>(g); }
    naive_index_kernel<<<M, 256, 0, stream>>>(QI, KI, WI, MASK);
    naive_attn_kernel<<<M, 512, 0, stream>>>(Q, Kb, V, MASK, AC);
    naive_conv_kernel<<<M, 512, 0, stream>>>(H, dw_w, dw_b, cg, cb, AC);
    { GemmArgs g{}; g.A = AC; g.W = w_out; g.K = DM; g.N = DM; g.mode_base = 5; g.x = x; g.yout = out;
      naive_gemm_kernel<true><<<dim3(M / 64, 16), 256, 0, stream>>>(g); }
    ln_rows_kernel<<<M / 4, 256, 0, stream>>>(out, l1g, l1b, X1B);
    { GemmArgs g{}; g.A = X1B; g.W = w_q; g.K = DM; g.N = DM; g.mode_base = 6; g.bout = QP;
      naive_gemm_kernel<true><<<dim3(M / 64, 16), 256, 0, stream>>>(g); }
    naive_route_kernel<<<M, 512, 0, stream>>>(QP, sub1, sub2, EID, GATE);
    naive_peer_kernel<<<M / 4, 256, 0, stream>>>(out, EID, GATE, pu, pv, l2g, l2b);
}
```

```cpp
#include <hip/hip_runtime.h>
#include <hip/hip_cooperative_groups.h>
#include <cstdint>
#include <cstdio>
namespace cg = cooperative_groups;

typedef unsigned short bf16_t;
typedef unsigned long long u64;

#ifndef MK_N_LAUNCHES
#define MK_N_LAUNCHES 1
#endif

constexpr int BATCH = 8, SEQ = 4096, DM = 1024, M = BATCH * SEQ;
constexpr int D_IN = 3144, OFF_Q = 0, OFF_K = 512, OFF_V = 1024, OFF_QI = 1536, OFF_KI = 2048, OFF_WI = 2112, OFF_CONV = 2120;
constexpr int NSEL = 256;
constexpr float LN_EPS = 1e-5f;
constexpr float ALPHA = 1.189207115002721f;
constexpr float C2 = 0.125f * 1.4426950408889634f;
constexpr int NT = 512;
constexpr int LDS_BYTES = 147456;

__device__ __forceinline__ unsigned f2bf(float f) { unsigned u = __float_as_uint(f); return (u + 0x7fffu + ((u >> 16) & 1u)) >> 16; }
__device__ __forceinline__ float bf2f(unsigned h) { return __uint_as_float(h << 16); }
__device__ __forceinline__ float bfround(float f) { return bf2f(f2bf(f)); }
__device__ __forceinline__ float wave_sum(float v) {
#pragma unroll
    for (int o = 1; o < 64; o <<= 1) v += __shfl_xor(v, o);
    return v;
}
__device__ __forceinline__ float wave_max(float v) {
#pragma unroll
    for (int o = 1; o < 64; o <<= 1) v = fmaxf(v, __shfl_xor(v, o));
    return v;
}

constexpr size_t MiB = 1u << 20;
constexpr size_t WS_ROPE = 1 * MiB;
constexpr size_t WS_Q = 16 * MiB;
constexpr size_t WS_K = 48 * MiB;
constexpr size_t WS_V = 80 * MiB;
constexpr size_t WS_QI = 112 * MiB;
constexpr size_t WS_KI = 144 * MiB;
constexpr size_t WS_WI = 148 * MiB;
constexpr size_t WS_H = 152 * MiB;
constexpr size_t WS_MASK = 184 * MiB;
constexpr size_t WS_AC = 200 * MiB;
constexpr size_t WS_X1B = 264 * MiB;
constexpr size_t WS_QP = 328 * MiB;
constexpr size_t WS_EID = 392 * MiB;
constexpr size_t WS_GATE = 408 * MiB;
constexpr size_t WS_END = 424 * MiB;

struct Args {
    const float *x, *w_in, *kg, *kb, *dw_w, *dw_b, *cg, *cb, *w_out, *l1g, *l1b, *w_q, *sub1, *sub2, *pu, *pv, *l2g, *l2b;
    float* out; unsigned char* ws; int ph_lo, ph_hi;
};
struct Bufs {
    float *cs, *sn, *WI, *GATE; bf16_t *Q, *Kb, *V, *QI, *KI, *H, *AC, *X1B, *QP; u64* MASK; int* EID;
    __device__ __forceinline__ explicit Bufs(unsigned char* ws) {
        cs = (float*)(ws + WS_ROPE); sn = cs + SEQ * 32; Q = (bf16_t*)(ws + WS_Q); Kb = (bf16_t*)(ws + WS_K); V = (bf16_t*)(ws + WS_V); QI = (bf16_t*)(ws + WS_QI); KI = (bf16_t*)(ws + WS_KI);
        H = (bf16_t*)(ws + WS_H); WI = (float*)(ws + WS_WI); MASK = (u64*)(ws + WS_MASK); AC = (bf16_t*)(ws + WS_AC); X1B = (bf16_t*)(ws + WS_X1B); QP = (bf16_t*)(ws + WS_QP);
        EID = (int*)(ws + WS_EID); GATE = (float*)(ws + WS_GATE);
    }
};

__device__ __forceinline__ void phase_rope_table(float* cs, float* sn) {
    for (int idx = blockIdx.x * NT + threadIdx.x; idx < SEQ * 32; idx += gridDim.x * NT) {
        const int pos = idx >> 5, i = idx & 31;
        const float inv_freq = powf(10000.0f, -(float)(2 * i) / 64.0f);
        const float angf = (float)pos * inv_freq;
        const double ang = (double)angf;
        const double twopi = 6.283185307179586476925286766559;
        double r = ang - twopi * rint(ang / twopi);
        const double r2 = r * r;
        double s = 0.0, c = 0.0, ts = r, tc = 1.0;
#pragma unroll 1
        for (int n = 0; n < 14; ++n) { s += ts; c += tc; tc = -tc * r2 / ((2 * n + 1) * (2 * n + 2)); ts = -ts * r2 / ((2 * n + 2) * (2 * n + 3)); }
        cs[idx] = (float)c; sn[idx] = (float)s;
    }
}

struct GemmArgs {
    const void* A; const float* W; int K, N, nct;
    int mode_base;
    const float* x; float* yout; bf16_t* bout;
    bf16_t *Q, *Kb, *V, *QI, *KI, *H; float* WI;
    const float *cs, *sn, *kg, *kb;
};
__device__ __forceinline__ int gemm_colmap(int mode_base, int ct, int sub, int j) {
    if (mode_base == 0) {
        if (ct < 32) return ct * 64 + j;
        if (ct == 32) return OFF_KI + j;
        if (ct == 33) return (j < 8) ? OFF_WI + j : -1;
        return (j < 32) ? OFF_CONV + sub * 32 + j : OFF_CONV + 512 + sub * 32 + (j - 32);
    }
    return ct * 64 + j;
}
template <bool A_BF16>
__device__ __forceinline__ void naive_gemm_phase(const GemmArgs g, char* lds) {
    float (*As)[132] = (float (*)[132])lds;
    float (*Bs)[68] = (float (*)[68])(lds + 16 * 132 * 4);
    float (*Cs)[65] = (float (*)[65])(lds + 16 * 132 * 4 + 16 * 68 * 4);
    const int tid = threadIdx.x, tx = tid & 15, ty = tid >> 4;
    const int nitems = (M / 128) * g.nct;
    for (int item = blockIdx.x; item < nitems; item += gridDim.x) {
        const int ct = item % g.nct, row0 = (item / g.nct) * 128;
        int mode, sub = 0;
        if (g.mode_base == 0) {
            if (ct < 32) { const int reg = ct >> 3; sub = ct & 7; mode = (reg == 2) ? 1 : 0; }
            else if (ct == 32) mode = 2; else if (ct == 33) mode = 3; else { mode = 4; sub = ct - 34; }
        } else { mode = g.mode_base; sub = ct; }
        int bcol[2];
#pragma unroll
        for (int j = 0; j < 2; ++j) bcol[j] = gemm_colmap(g.mode_base, ct, sub, (tid & 31) * 2 + j);
        float acc[4][4] = {};
        const int K = g.K, N = g.N;
        for (int k0 = 0; k0 < K; k0 += 16) {
            {   const int r = tid >> 2, kq = tid & 3; float a[4];
                if (A_BF16) { const bf16_t* ap = (const bf16_t*)g.A + (size_t)(row0 + r) * K + k0 + 4 * kq; const uint2 v = *(const uint2*)ap;
                    a[0] = bf2f(v.x & 0xffff); a[1] = bf2f(v.x >> 16); a[2] = bf2f(v.y & 0xffff); a[3] = bf2f(v.y >> 16); }
                else { const float4 v = *(const float4*)((const float*)g.A + (size_t)(row0 + r) * K + k0 + 4 * kq); a[0] = v.x; a[1] = v.y; a[2] = v.z; a[3] = v.w; }
#pragma unroll
                for (int i = 0; i < 4; ++i) As[4 * kq + i][r] = a[i];
            }
            {   const int k = tid >> 5;
#pragma unroll
                for (int j = 0; j < 2; ++j) Bs[k][(tid & 31) * 2 + j] = (bcol[j] >= 0) ? g.W[(size_t)(k0 + k) * N + bcol[j]] : 0.f;
            }
            __syncthreads();
#pragma unroll
            for (int k = 0; k < 16; ++k) {
                float a[4], b[4];
#pragma unroll
                for (int i = 0; i < 4; ++i) a[i] = As[k][ty * 4 + i];
#pragma unroll
                for (int j = 0; j < 4; ++j) b[j] = Bs[k][tx * 4 + j];
#pragma unroll
                for (int i = 0; i < 4; ++i)
#pragma unroll
                    for (int j = 0; j < 4; ++j) acc[i][j] = fmaf(a[i], b[j], acc[i][j]);
            }
            __syncthreads();
        }
#pragma unroll
        for (int i = 0; i < 4; ++i)
#pragma unroll
            for (int j = 0; j < 4; ++j) Cs[ty * 4 + i][tx * 4 + j] = acc[i][j];
        __syncthreads();
        if (mode == 0) {
            const int reg = ct >> 3; bf16_t* dst = reg == 0 ? g.Q : (reg == 1 ? g.Kb : g.QI); const float sc = (reg == 0) ? C2 : 1.f;
            for (int e = tid; e < 128 * 32; e += NT) { const int r = e >> 5, i = e & 31; const int m = row0 + r, pos = m & (SEQ - 1);
                const float a = Cs[r][i], b = Cs[r][i + 32], c = g.cs[pos * 32 + i], s = g.sn[pos * 32 + i];
                const float o1 = a * c - b * s, o2 = b * c + a * s;
                *(unsigned*)(dst + (size_t)m * 512 + sub * 64 + 2 * i) = f2bf(o1 * sc) | (f2bf(o2 * sc) << 16); }
        } else if (mode == 1) {
            for (int e = tid; e < 128 * 64; e += NT) { const int r = e >> 6, j = e & 63; g.V[(size_t)(row0 + r) * 512 + sub * 64 + j] = (bf16_t)f2bf(Cs[r][j]); }
        } else if (mode == 2) {
            if (tid < 128) { const int r = tid; float mu = 0.f; for (int j = 0; j < 64; ++j) mu += Cs[r][j]; mu *= (1.f / 64.f);
                float var = 0.f; for (int j = 0; j < 64; ++j) { const float d = Cs[r][j] - mu; var += d * d; } var *= (1.f / 64.f);
                const float rs = rsqrtf(var + LN_EPS); const int m = row0 + r, pos = m & (SEQ - 1);
                for (int i = 0; i < 32; ++i) { const float a = (Cs[r][i] - mu) * rs * g.kg[i] + g.kb[i], b = (Cs[r][i + 32] - mu) * rs * g.kg[i + 32] + g.kb[i + 32];
                    const float c = g.cs[pos * 32 + i], s = g.sn[pos * 32 + i];
                    *(unsigned*)(g.KI + (size_t)m * 64 + 2 * i) = f2bf(a * c - b * s) | (f2bf(b * c + a * s) << 16); } }
        } else if (mode == 3) {
            for (int e = tid; e < 128 * 8; e += NT) { const int r = e >> 3, j = e & 7; g.WI[(size_t)(row0 + r) * 8 + j] = Cs[r][j] * 0.35355339059327373f; }
        } else if (mode == 4) {
            for (int e = tid; e < 128 * 32; e += NT) { const int r = e >> 5, j = e & 31; const float u = Cs[r][j], gt = Cs[r][j + 32];
                g.H[(size_t)(row0 + r) * 512 + sub * 32 + j] = (bf16_t)f2bf(u / (1.f + __expf(-gt))); }
        } else if (mode == 5) {
            for (int e = tid; e < 128 * 64; e += NT) { const int r = e >> 6, j = e & 63; const size_t o = (size_t)(row0 + r) * N + ct * 64 + j; g.yout[o] = ALPHA * g.x[o] + Cs[r][j]; }
        } else {
            for (int e = tid; e < 128 * 64; e += NT) { const int r = e >> 6, j = e & 63; g.bout[(size_t)(row0 + r) * N + ct * 64 + j] = (bf16_t)f2bf(Cs[r][j]); }
        }
        __syncthreads();
    }
}

__device__ __forceinline__ unsigned sortkey(float f) { const unsigned u = __float_as_uint(f); return (u & 0x80000000u) ? ~u : (u | 0x80000000u); }
__device__ __forceinline__ int block_count_ge(const unsigned* keys, int n, unsigned thr, int* red) {
    const int tid = threadIdx.x;
    int c = 0; for (int s = tid; s < n; s += NT) c += (keys[s] >= thr) ? 1 : 0;
    c = (int)wave_sum((float)c);
    __syncthreads(); if ((tid & 63) == 0) red[tid >> 6] = c; __syncthreads();
    return red[0] + red[1] + red[2] + red[3] + red[4] + red[5] + red[6] + red[7];
}
__device__ __forceinline__ void naive_index_phase(const bf16_t* __restrict__ QI, const bf16_t* __restrict__ KI, const float* __restrict__ WI, u64* __restrict__ MASK, char* lds) {
    float* qs = (float*)lds; float* wsh = qs + 512; unsigned* keys = (unsigned*)(wsh + 8); int* red = (int*)(keys + SEQ); int* s_cut = red + 8;
    const int tid = threadIdx.x;
    for (int m = blockIdx.x; m < M; m += gridDim.x) {
        const int b = m >> 12, t = m & (SEQ - 1), n = t + 1;
        for (int e = tid; e < 512; e += NT) qs[e] = bf2f(QI[(size_t)m * 512 + e]);
        if (tid < 8) wsh[tid] = WI[(size_t)m * 8 + tid];
        __syncthreads();
        for (int s = tid; s < n; s += NT) {
            const uint4* kp = (const uint4*)(KI + (size_t)(b * SEQ + s) * 64);
            float kv[64];
#pragma unroll
            for (int c = 0; c < 8; ++c) { const uint4 v = kp[c]; kv[8 * c + 0] = bf2f(v.x & 0xffff); kv[8 * c + 1] = bf2f(v.x >> 16); kv[8 * c + 2] = bf2f(v.y & 0xffff); kv[8 * c + 3] = bf2f(v.y >> 16);
                kv[8 * c + 4] = bf2f(v.z & 0xffff); kv[8 * c + 5] = bf2f(v.z >> 16); kv[8 * c + 6] = bf2f(v.w & 0xffff); kv[8 * c + 7] = bf2f(v.w >> 16); }
            float sc = 0.f;
#pragma unroll 1
            for (int h = 0; h < 8; ++h) { float d = 0.f;
#pragma unroll
                for (int j = 0; j < 64; ++j) d = fmaf(qs[h * 64 + j], kv[j], d);
                sc = fmaf(wsh[h], fmaxf(d, 0.f), sc); }
            keys[s] = sortkey(sc);
        }
        __syncthreads();
        unsigned Kth = 0; int cut = SEQ;
        if (n > NSEL) {
            for (int bit = 31; bit >= 0; --bit) { const unsigned cand = Kth | (1u << bit); const int c = block_count_ge(keys, n, cand, red); if (c >= NSEL) Kth = cand; }
            const int cge = block_count_ge(keys, n, Kth, red);
            const int cgt = (Kth == 0xffffffffu) ? 0 : block_count_ge(keys, n, Kth + 1u, red);
            const int ceq = cge - cgt;
            const int need = NSEL - cgt;
            if (ceq > need) {
                if (tid == 0) { int c = 0, cu = 0; for (int s = 0; s < n; ++s) if (keys[s] == Kth) { if (++c == need) { cu = s; break; } } *s_cut = cu; }
                __syncthreads(); cut = *s_cut;
            }
        }
        const int w = tid >> 6, lane = tid & 63;
        for (int kt = w; kt < 64; kt += 8) {
            const int s = kt * 64 + lane; bool sel = false;
            if (s < n) { if (n <= NSEL) sel = true; else { const unsigned k = keys[s]; sel = (k > Kth) || (k == Kth && s <= cut); } }
            const u64 bal = __ballot(sel);
            if (lane == 0) MASK[((size_t)b * 64 + kt) * SEQ + t] = bal;
        }
        __syncthreads();
    }
}

__device__ __forceinline__ void naive_attn_phase(const bf16_t* __restrict__ Q, const bf16_t* __restrict__ Kb, const bf16_t* __restrict__ V, const u64* __restrict__ MASK, bf16_t* __restrict__ AC, char* lds) {
    int* list = (int*)lds; int* s_cnt = list + NSEL + 64; float (*qsh)[64] = (float (*)[64])(s_cnt + 4); float (*psh)[NSEL] = (float (*)[NSEL])(qsh + 8);
    const int tid = threadIdx.x, h = tid >> 6, lane = tid & 63;
    for (int m = blockIdx.x; m < M; m += gridDim.x) {
        const int b = m >> 12, t = m & (SEQ - 1);
        qsh[h][lane] = bf2f(Q[(size_t)m * 512 + h * 64 + lane]);
        if (tid < 64) {
            const u64 wd = MASK[((size_t)b * 64 + tid) * SEQ + t];
            const int pc = __popcll(wd);
            int incl = pc;
#pragma unroll
            for (int o = 1; o < 64; o <<= 1) { const int v = __shfl_up(incl, o); if (lane >= o) incl += v; }
            int pos = incl - pc; u64 x = wd;
            while (x) { const int bidx = __ffsll((long long)x) - 1; x &= x - 1; if (pos < NSEL) list[pos] = tid * 64 + bidx; ++pos; }
            if (tid == 63) *s_cnt = incl;
        }
        __syncthreads();
        const int cnt = min(*s_cnt, NSEL);
        float sv[4]; float mx = -INFINITY;
#pragma unroll
        for (int r = 0; r < 4; ++r) { const int j = lane + 64 * r; sv[r] = -INFINITY;
            if (j < cnt) { const int s = list[j]; const uint4* kp = (const uint4*)(Kb + (size_t)(b * SEQ + s) * 512 + h * 64); float d = 0.f;
#pragma unroll
                for (int c = 0; c < 8; ++c) { const uint4 v = kp[c]; const float* q = &qsh[h][8 * c];
                    d = fmaf(q[0], bf2f(v.x & 0xffff), d); d = fmaf(q[1], bf2f(v.x >> 16), d); d = fmaf(q[2], bf2f(v.y & 0xffff), d); d = fmaf(q[3], bf2f(v.y >> 16), d);
                    d = fmaf(q[4], bf2f(v.z & 0xffff), d); d = fmaf(q[5], bf2f(v.z >> 16), d); d = fmaf(q[6], bf2f(v.w & 0xffff), d); d = fmaf(q[7], bf2f(v.w >> 16), d); }
                sv[r] = d; mx = fmaxf(mx, d); } }
        mx = wave_max(mx);
        float l = 0.f;
#pragma unroll
        for (int r = 0; r < 4; ++r) { const int j = lane + 64 * r; const float p = (j < cnt) ? exp2f(sv[r] - mx) : 0.f; l += p; psh[h][j] = p; }
        l = wave_sum(l);
        __syncthreads();
        float o = 0.f;
        for (int j = 0; j < cnt; ++j) { const int s = list[j]; o = fmaf(psh[h][j], bf2f(V[(size_t)(b * SEQ + s) * 512 + h * 64 + lane]), o); }
        AC[(size_t)m * 1024 + h * 64 + lane] = (bf16_t)f2bf(o / l);
        __syncthreads();
    }
}

__device__ __forceinline__ void naive_conv_phase(const bf16_t* __restrict__ H, const float* __restrict__ dw_w, const float* __restrict__ dw_b, const float* __restrict__ g, const float* __restrict__ bta, bf16_t* __restrict__ AC, char* lds) {
    float* red = (float*)lds; float* red2 = red + 8;
    const int c = threadIdx.x;
    for (int m = blockIdx.x; m < M; m += gridDim.x) {
        const int t = m & (SEQ - 1);
        float acc = dw_b[c];
        for (int j = 0; j < 31; ++j) { const int tt = t - 30 + j; if (tt >= 0) acc = fmaf(dw_w[j * 512 + c], bf2f(H[(size_t)(m - 30 + j) * 512 + c]), acc); }
        float s = wave_sum(acc); if ((c & 63) == 0) red[c >> 6] = s; __syncthreads();
        float mu = 0.f; for (int i = 0; i < 8; ++i) mu += red[i]; mu *= (1.f / 512.f);
        const float d = acc - mu; float s2 = wave_sum(d * d); if ((c & 63) == 0) red2[c >> 6] = s2; __syncthreads();
        float var = 0.f; for (int i = 0; i < 8; ++i) var += red2[i]; var *= (1.f / 512.f);
        const float y = d * rsqrtf(var + LN_EPS) * g[c] + bta[c];
        AC[(size_t)m * 1024 + 512 + c] = (bf16_t)f2bf(y / (1.f + __expf(-y)));
        __syncthreads();
    }
}

__device__ __forceinline__ void ln_rows_phase(float* __restrict__ y, const float* __restrict__ g, const float* __restrict__ bta, bf16_t* __restrict__ xb) {
    const int lane = threadIdx.x & 63;
    for (int row = blockIdx.x * 8 + (threadIdx.x >> 6); row < M; row += gridDim.x * 8) {
        float4* yr = (float4*)(y + (size_t)row * DM) + lane; float4 v[4]; float s = 0.f;
#pragma unroll
        for (int j = 0; j < 4; ++j) { v[j] = yr[64 * j]; s += (v[j].x + v[j].y) + (v[j].z + v[j].w); }
        const float mu = wave_sum(s) * (1.f / DM); float s2 = 0.f;
#pragma unroll
        for (int j = 0; j < 4; ++j) { v[j].x -= mu; v[j].y -= mu; v[j].z -= mu; v[j].w -= mu; s2 += (v[j].x * v[j].x + v[j].y * v[j].y) + (v[j].z * v[j].z + v[j].w * v[j].w); }
        const float rs = rsqrtf(wave_sum(s2) * (1.f / DM) + LN_EPS);
#pragma unroll
        for (int j = 0; j < 4; ++j) { const int c = 256 * j + 4 * lane; const float4 gg = *(const float4*)(g + c), bb = *(const float4*)(bta + c);
            float4 o; o.x = v[j].x * rs * gg.x + bb.x; o.y = v[j].y * rs * gg.y + bb.y; o.z = v[j].z * rs * gg.z + bb.z; o.w = v[j].w * rs * gg.w + bb.w;
            yr[64 * j] = o; uint2 pk; pk.x = f2bf(o.x) | (f2bf(o.y) << 16); pk.y = f2bf(o.z) | (f2bf(o.w) << 16); *(uint2*)(xb + (size_t)row * DM + c) = pk; }
    }
}

__device__ __forceinline__ void wave_argmax(float& v, int& i) {
#pragma unroll
    for (int o = 1; o < 64; o <<= 1) { const float ov = __shfl_xor(v, o); const int oi = __shfl_xor(i, o); if (ov > v || (ov == v && oi < i)) { v = ov; i = oi; } }
}
__device__ __forceinline__ void naive_route_phase(const bf16_t* __restrict__ QP, const float* __restrict__ sub1, const float* __restrict__ sub2, int* __restrict__ EID, float* __restrict__ GATE) {
    const int h = threadIdx.x >> 6, lane = threadIdx.x & 63;
    for (int m = blockIdx.x; m < M; m += gridDim.x) {
        float q1 = bf2f(QP[(size_t)m * 1024 + h * 128 + lane]), q2 = bf2f(QP[(size_t)m * 1024 + h * 128 + 64 + lane]);
        float s1[2] = {0.f, 0.f}, s2[2] = {0.f, 0.f};
        for (int d = 0; d < 64; ++d) { const float a = __shfl(q1, d), b = __shfl(q2, d);
#pragma unroll
            for (int r = 0; r < 2; ++r) { const int n = lane + 64 * r; s1[r] = fmaf(a, bfround(sub1[((size_t)h * 128 + n) * 64 + d]), s1[r]); s2[r] = fmaf(b, bfround(sub2[((size_t)h * 128 + n) * 64 + d]), s2[r]); } }
        float v1 = -INFINITY, v2 = -INFINITY; int i1 = 0, i2 = 0;
        for (int r = 0; r < 16; ++r) {
            { float bv = s1[0]; int bi = lane; if (s1[1] > bv) { bv = s1[1]; bi = lane + 64; } wave_argmax(bv, bi); if (lane == r) { v1 = bv; i1 = bi; } if (bi == lane) s1[0] = -INFINITY; if (bi == lane + 64) s1[1] = -INFINITY; }
            { float bv = s2[0]; int bi = lane; if (s2[1] > bv) { bv = s2[1]; bi = lane + 64; } wave_argmax(bv, bi); if (lane == r) { v2 = bv; i2 = bi; } if (bi == lane) s2[0] = -INFINITY; if (bi == lane + 64) s2[1] = -INFINITY; }
        }
        float cand[4];
#pragma unroll
        for (int j = 0; j < 4; ++j) { const int c = lane + 64 * j; cand[j] = __shfl(v1, c >> 4) + __shfl(v2, c & 15); }
        float ts = -INFINITY; int tp = 0;
        for (int r = 0; r < 16; ++r) {
            float bv = cand[0]; int bi = lane;
#pragma unroll
            for (int j = 1; j < 4; ++j) if (cand[j] > bv) { bv = cand[j]; bi = lane + 64 * j; }
            wave_argmax(bv, bi); if (lane == r) { ts = bv; tp = bi; }
#pragma unroll
            for (int j = 0; j < 4; ++j) if (bi == lane + 64 * j) cand[j] = -INFINITY;
        }
        const int ea = __shfl(i1, tp >> 4), eb = __shfl(i2, tp & 15);
        const float mx = __shfl(ts, 0);
        float p = (lane < 16) ? __expf(ts - mx) : 0.f;
        const float l = wave_sum(p);
        if (lane < 16) { EID[(size_t)m * 128 + h * 16 + lane] = ea * 128 + eb; GATE[(size_t)m * 128 + h * 16 + lane] = p / l; }
    }
}

__device__ __forceinline__ void naive_peer_phase(float* __restrict__ xio, const int* __restrict__ EID, const float* __restrict__ GATE, const float* __restrict__ U, const float* __restrict__ Vt,
                                                 const float* __restrict__ g, const float* __restrict__ bta) {
    const int lane = threadIdx.x & 63;
    for (int m = blockIdx.x * 8 + (threadIdx.x >> 6); m < M; m += gridDim.x * 8) {
        float4* xr = (float4*)(xio + (size_t)m * DM) + lane; float4 x[4], acc[4];
#pragma unroll
        for (int j = 0; j < 4; ++j) { x[j] = xr[64 * j]; acc[j] = make_float4(0.f, 0.f, 0.f, 0.f); }
        for (int k = 0; k < 128; ++k) {
            const int e = EID[(size_t)m * 128 + k]; const float gt = GATE[(size_t)m * 128 + k];
            const float4* ur = (const float4*)(U + (size_t)e * DM) + lane; const float4* vr = (const float4*)(Vt + (size_t)e * DM) + lane;
            float d = 0.f;
#pragma unroll
            for (int j = 0; j < 4; ++j) { const float4 u = ur[64 * j]; d += (u.x * x[j].x + u.y * x[j].y) + (u.z * x[j].z + u.w * x[j].w); }
            d = wave_sum(d);
            const float c = gt * 0.5f * d * (1.f + erff(d * 0.70710678118654752f));
#pragma unroll
            for (int j = 0; j < 4; ++j) { const float4 v = vr[64 * j]; acc[j].x = fmaf(c, v.x, acc[j].x); acc[j].y = fmaf(c, v.y, acc[j].y); acc[j].z = fmaf(c, v.z, acc[j].z); acc[j].w = fmaf(c, v.w, acc[j].w); }
        }
        float s = 0.f;
#pragma unroll
        for (int j = 0; j < 4; ++j) { acc[j].x += ALPHA * x[j].x; acc[j].y += ALPHA * x[j].y; acc[j].z += ALPHA * x[j].z; acc[j].w += ALPHA * x[j].w; s += (acc[j].x + acc[j].y) + (acc[j].z + acc[j].w); }
        const float mu = wave_sum(s) * (1.f / DM); float s2 = 0.f;
#pragma unroll
        for (int j = 0; j < 4; ++j) { acc[j].x -= mu; acc[j].y -= mu; acc[j].z -= mu; acc[j].w -= mu; s2 += (acc[j].x * acc[j].x + acc[j].y * acc[j].y) + (acc[j].z * acc[j].z + acc[j].w * acc[j].w); }
        const float rs = rsqrtf(wave_sum(s2) * (1.f / DM) + LN_EPS);
#pragma unroll
        for (int j = 0; j < 4; ++j) { const int c = 256 * j + 4 * lane; const float4 gg = *(const float4*)(g + c), bb = *(const float4*)(bta + c);
            float4 o; o.x = acc[j].x * rs * gg.x + bb.x; o.y = acc[j].y * rs * gg.y + bb.y; o.z = acc[j].z * rs * gg.z + bb.z; o.w = acc[j].w * rs * gg.w + bb.w; xr[64 * j] = o; }
    }
}

constexpr int N_PHASES = 10;
__global__ void __launch_bounds__(NT, 2) mega_fwd(Args a) {
    extern __shared__ __attribute__((aligned(16))) char lds[];
    cg::grid_group grid = cg::this_grid();
    const Bufs B(a.ws);
    const int lo = a.ph_lo, hi = a.ph_hi;
#define IN(k) (lo <= (k) && (k) < hi)
#define SEAM(k) do { if (IN(k) && IN((k) + 1)) grid.sync(); } while (0)
    if (IN(0)) { phase_rope_table(B.cs, B.sn); } SEAM(0);
    if (IN(1)) { GemmArgs g{}; g.A = a.x; g.W = a.w_in; g.K = DM; g.N = D_IN; g.nct = 50; g.mode_base = 0; g.Q = B.Q; g.Kb = B.Kb; g.V = B.V; g.QI = B.QI; g.KI = B.KI; g.H = B.H; g.WI = B.WI; g.cs = B.cs; g.sn = B.sn; g.kg = a.kg; g.kb = a.kb;
                 naive_gemm_phase<false>(g, lds); } SEAM(1);
    if (IN(2)) { naive_index_phase(B.QI, B.KI, B.WI, B.MASK, lds); } SEAM(2);
    if (IN(3)) { naive_attn_phase(B.Q, B.Kb, B.V, B.MASK, B.AC, lds); } SEAM(3);
    if (IN(4)) { naive_conv_phase(B.H, a.dw_w, a.dw_b, a.cg, a.cb, B.AC, lds); } SEAM(4);
    if (IN(5)) { GemmArgs g{}; g.A = B.AC; g.W = a.w_out; g.K = DM; g.N = DM; g.nct = 16; g.mode_base = 5; g.x = a.x; g.yout = a.out; naive_gemm_phase<true>(g, lds); } SEAM(5);
    if (IN(6)) { ln_rows_phase(a.out, a.l1g, a.l1b, B.X1B); } SEAM(6);
    if (IN(7)) { GemmArgs g{}; g.A = B.X1B; g.W = a.w_q; g.K = DM; g.N = DM; g.nct = 16; g.mode_base = 6; g.bout = B.QP; naive_gemm_phase<true>(g, lds); } SEAM(7);
    if (IN(8)) { naive_route_phase(B.QP, a.sub1, a.sub2, B.EID, B.GATE); } SEAM(8);
    if (IN(9)) { naive_peer_phase(a.out, B.EID, B.GATE, a.pu, a.pv, a.l2g, a.l2b); }
#undef IN
#undef SEAM
}

extern "C" void kernel_launch(void* const* d_in, const int* in_sizes, int n_in, void* d_out, int out_size, void* d_ws, size_t ws_size, hipStream_t stream) {
    static int grid = 0;
    if (grid == 0) {
        if (n_in != 18 || out_size != M * DM || ws_size < WS_END) { fprintf(stderr, "kernel_launch: unexpected shapes (n_in %d out %d ws %zu)\n", n_in, out_size, ws_size); grid = -1; return; }
        int dev = 0, cus = 0, per_cu = 0;
        hipGetDevice(&dev); hipDeviceGetAttribute(&cus, hipDeviceAttributeMultiprocessorCount, dev);
        if (hipFuncSetAttribute((const void*)mega_fwd, hipFuncAttributeMaxDynamicSharedMemorySize, LDS_BYTES) != hipSuccess) { fprintf(stderr, "kernel_launch: hipFuncSetAttribute failed\n"); grid = -1; return; }
        if (hipOccupancyMaxActiveBlocksPerMultiprocessor(&per_cu, (const void*)mega_fwd, NT, LDS_BYTES) != hipSuccess || per_cu < 1) { fprintf(stderr, "kernel_launch: occupancy query says %d\n", per_cu); (void)hipGetLastError(); per_cu = 1; }
        grid = cus * 1;
        fprintf(stderr, "kernel_launch: cus %d per_cu %d grid %d\n", cus, per_cu, grid);
    }
    if (grid < 0) return;
    Args a{};
    a.x = (const float*)d_in[0]; a.w_in = (const float*)d_in[1]; a.kg = (const float*)d_in[2]; a.kb = (const float*)d_in[3];
    a.dw_w = (const float*)d_in[4]; a.dw_b = (const float*)d_in[5]; a.cg = (const float*)d_in[6]; a.cb = (const float*)d_in[7];
    a.w_out = (const float*)d_in[8]; a.l1g = (const float*)d_in[9]; a.l1b = (const float*)d_in[10]; a.w_q = (const float*)d_in[11];
    a.sub1 = (const float*)d_in[12]; a.sub2 = (const float*)d_in[13]; a.pu = (const float*)d_in[14]; a.pv = (const float*)d_in[15];
    a.l2g = (const float*)d_in[16]; a.l2b = (const float*)d_in[17];
    a.out = (float*)d_out; a.ws = (unsigned char*)d_ws;
#if MK_N_LAUNCHES == 1
    a.ph_lo = 0; a.ph_hi = N_PHASES;
    void* args[] = {&a};
    hipError_t e = hipLaunchCooperativeKernel((const void*)mega_fwd, dim3(grid), dim3(NT), args, LDS_BYTES, stream);
    if (e != hipSuccess) fprintf(stderr, "kernel_launch: cooperative launch failed: %s (grid %d)\n", hipGetErrorString(e), grid);
#else
    for (int p = 0; p < N_PHASES; ++p) { a.ph_lo = p; a.ph_hi = p + 1; hipLaunchKernelGGL(mega_fwd, dim3(grid), dim3(NT), LDS_BYTES, stream, a); }
#endif
}
```
